# Optimizing an MI355X kernel written in HIP

```python
import jax, jax.numpy as jnp
from jax import lax
import numpy as np

D_MODEL = 1024
BATCH = 16
SEQ = 2048
DEPTH = 1

CHUNK = 128
A_GROUPS = 4
A_WIDTH = 512
A_GROUP_DIM = A_WIDTH // A_GROUPS
N_HEADS = 8
N_KV_HEADS = 2
HEAD_DIM = 64
Q_DIM = N_HEADS * HEAD_DIM
KV_DIM = N_KV_HEADS * HEAD_DIM
WINDOW = 128
BLOCK = 128
N_BUCKETS = 32
MAX_DISTANCE = 128
D_FF = 2816
CONV_WIDTH = 3
EPS = 1e-6
NEG_INF = -1e30
IN_SIZES = (A_WIDTH, A_WIDTH, Q_DIM, KV_DIM, KV_DIM, D_MODEL, D_MODEL)
IN_DIM = sum(IN_SIZES)

kernel_name = "hybrid_gated_gmlp_swa_convffn"


def rmsnorm(x, g):
    xf = x.astype(jnp.float32)
    r = lax.rsqrt(jnp.mean(xf * xf, axis=-1, keepdims=True) + EPS)
    return (xf * r * g.astype(jnp.float32)).astype(x.dtype)


def band_buckets():
    i = np.arange(BLOCK)[:, None]
    j = np.arange(2 * BLOCK)[None, :]
    dist = i + BLOCK - j
    valid = (dist >= 0) & (dist < WINDOW)
    d = np.clip(dist, 0, None)
    max_exact = N_BUCKETS // 2
    large = max_exact + (np.log(np.maximum(d, 1) / max_exact) / np.log(MAX_DISTANCE / max_exact)
                         * (N_BUCKETS - max_exact)).astype(np.int32)
    large = np.minimum(large, N_BUCKETS - 1)
    buckets = np.where(d < max_exact, d, large).astype(np.int32)
    return buckets, valid


def spatial_gating(u, v, g_sgu, w_s, b_s):
    B, S = v.shape[0], v.shape[1]
    nc = S // CHUNK
    v = rmsnorm(v, g_sgu).reshape(B, nc, CHUNK, A_GROUPS, A_GROUP_DIM)
    causal = jnp.tril(jnp.ones((CHUNK, CHUNK), dtype=w_s.dtype))
    w_masked = w_s * causal[None]
    s = jnp.einsum('gts,bcsgd->bctgd', w_masked, v) + jnp.transpose(b_s)[None, None, :, :, None]
    return u * s.reshape(B, S, A_WIDTH)


def swa_sink_attention(q, k, v, sinks, rel_bias):
    B, S = q.shape[0], q.shape[1]
    nb = S // BLOCK
    G = N_HEADS // N_KV_HEADS
    qb = q.reshape(B, nb, BLOCK, N_KV_HEADS, G, HEAD_DIM)
    kb = k.reshape(B, nb, BLOCK, N_KV_HEADS, HEAD_DIM)
    vb = v.reshape(B, nb, BLOCK, N_KV_HEADS, HEAD_DIM)
    pad = ((0, 0), (1, 0), (0, 0), (0, 0), (0, 0))
    kw = jnp.concatenate([jnp.pad(kb, pad)[:, :-1], kb], axis=2)
    vw = jnp.concatenate([jnp.pad(vb, pad)[:, :-1], vb], axis=2)
    scale = HEAD_DIM ** -0.5
    scores = jnp.einsum('bnqhgd,bnkhd->bnhgqk', qb, kw).astype(jnp.float32) * scale
    buckets, valid = band_buckets()
    bias = rel_bias[buckets].astype(jnp.float32)
    bias = jnp.transpose(bias, (2, 0, 1)).reshape(N_KV_HEADS, G, BLOCK, 2 * BLOCK)
    first_ok = (np.arange(nb)[:, None] > 0) | (np.arange(2 * BLOCK)[None, :] >= BLOCK)
    mask = valid[None, :, :] & first_ok[:, None, :]
    scores = jnp.where(mask[None, :, None, None], scores + bias[None, None], NEG_INF)
    sink = sinks.astype(jnp.float32).reshape(N_KV_HEADS, G)[None, None, :, :, None, None]
    m = jnp.maximum(jnp.max(scores, axis=-1, keepdims=True), sink)
    p = jnp.exp(scores - m)
    probs = p / (jnp.sum(p, axis=-1, keepdims=True) + jnp.exp(sink - m))
    out = jnp.einsum('bnhgqk,bnkhd->bnqhgd', probs.astype(vw.dtype), vw)
    return out.reshape(B, S, Q_DIM)


def causal_depthwise_conv(x, w, b):
    S = x.shape[1]
    xp = jnp.pad(x, ((0, 0), (CONV_WIDTH - 1, 0), (0, 0)))
    y = w[0] * xp[:, 0:S]
    for j in range(1, CONV_WIDTH):
        y = y + w[j] * xp[:, j:j + S]
    return y + b


def setup_inputs(seed: int = 0) -> dict:
    key = jax.random.key(seed)
    ks = jax.random.split(key, 20)
    f32 = jnp.float32
    nrm = lambda k, shape, s: (jax.random.normal(k, shape, f32) * s)
    L = DEPTH
    return {
        "x": nrm(ks[0], (BATCH, SEQ, D_MODEL), 1.0),
        "g_mix": 1.0 + nrm(ks[1], (L, D_MODEL), 0.05),
        "w_in": nrm(ks[2], (L, D_MODEL, IN_DIM), D_MODEL ** -0.5),
        "g_sgu": 1.0 + nrm(ks[3], (L, A_WIDTH), 0.05),
        "w_s": nrm(ks[4], (L, A_GROUPS, CHUNK, CHUNK), CHUNK ** -0.5),
        "b_s": 1.0 + nrm(ks[5], (L, A_GROUPS, CHUNK), 0.1),
        "sinks": nrm(ks[6], (L, N_HEADS), 0.5),
        "rel_bias": nrm(ks[7], (N_BUCKETS, N_HEADS), 0.5),
        "w_pa": nrm(ks[8], (L, A_WIDTH, D_MODEL), A_WIDTH ** -0.5),
        "w_pb": nrm(ks[9], (L, Q_DIM, D_MODEL), Q_DIM ** -0.5),
        "w_out": nrm(ks[10], (L, D_MODEL, D_MODEL), D_MODEL ** -0.5),
        "g_ffn": 1.0 + nrm(ks[11], (L, D_MODEL), 0.05),
        "w_up": nrm(ks[12], (L, D_MODEL, 2 * D_FF), D_MODEL ** -0.5),
        "w_conv": nrm(ks[13], (L, CONV_WIDTH, 2 * D_FF), CONV_WIDTH ** -0.5),
        "b_conv": nrm(ks[14], (L, 2 * D_FF), 0.01),
        "w_down": nrm(ks[15], (L, D_FF, D_MODEL), D_FF ** -0.5),
        "g_final": 1.0 + nrm(ks[16], (D_MODEL,), 0.05),
    }


def reference(x, g_mix, w_in, g_sgu, w_s, b_s, sinks, rel_bias, w_pa, w_pb, w_out,
              g_ffn, w_up, w_conv, b_conv, w_down, g_final):
    splits = [int(c) for c in np.cumsum(IN_SIZES)[:-1]]
    B, S = x.shape[0], x.shape[1]
    for l in range(DEPTH):
        h = rmsnorm(x, g_mix[l])
        proj = jnp.einsum('bsd,de->bse', h, w_in[l])
        pu, pv, q, k, v, gate_a, gate_b = jnp.split(proj, splits, axis=-1)
        y_a = spatial_gating(jax.nn.gelu(pu), jax.nn.gelu(pv), g_sgu[l], w_s[l], b_s[l])
        y_b = swa_sink_attention(q.reshape(B, S, N_HEADS, HEAD_DIM),
                                 k.reshape(B, S, N_KV_HEADS, HEAD_DIM),
                                 v.reshape(B, S, N_KV_HEADS, HEAD_DIM),
                                 sinks[l], rel_bias)
        merged = (jax.nn.sigmoid(gate_a) * jnp.einsum('bse,ed->bsd', y_a, w_pa[l])
                  + jax.nn.sigmoid(gate_b) * jnp.einsum('bse,ed->bsd', y_b, w_pb[l]))
        x = x + jnp.einsum('bsd,de->bse', merged, w_out[l])
        h2 = rmsnorm(x, g_ffn[l])
        up = causal_depthwise_conv(jnp.einsum('bsd,df->bsf', h2, w_up[l]), w_conv[l], b_conv[l])
        gate, val = jnp.split(up, 2, axis=-1)
        x = x + jnp.einsum('bsf,fd->bsd', jax.nn.silu(gate) * val, w_down[l])
    return rmsnorm(x, g_final)
```

```cpp
#include <hip/hip_runtime.h>
#include <cstdio>
#include <cstdint>

namespace {
constexpr int D = 1024, NB = 16, S = 2048;
constexpr int AW = 512, QD = 512, KVD = 128, DFF = 2816, IN_DIM = 3840;
constexpr int NH = 8, HD = 64, CH = 128;
constexpr float EPS = 1e-6f;

__device__ const unsigned char BUCKET[128] = {0,1,2,3,4,5,6,7,8,9,10,11,12,13,14,15,16,16,16,17,17,18,18,18,19,19,19,20,20,20,20,21,21,21,21,22,22,22,22,22,23,23,23,23,23,23,24,24,24,24,24,24,25,25,25,25,25,25,25,26,26,26,26,26,26,26,26,27,27,27,27,27,27,27,27,27,27,28,28,28,28,28,28,28,28,28,28,29,29,29,29,29,29,29,29,29,29,29,29,30,30,30,30,30,30,30,30,30,30,30,30,30,30,31,31,31,31,31,31,31,31,31,31,31,31,31,31,31};

__device__ __forceinline__ float wave_sum(float v) {
#pragma unroll
    for (int o = 1; o < 64; o <<= 1) v += __shfl_xor(v, o);
    return v;
}
__device__ __forceinline__ float wave_max(float v) {
#pragma unroll
    for (int o = 1; o < 64; o <<= 1) v = fmaxf(v, __shfl_xor(v, o));
    return v;
}
__device__ __forceinline__ float gelu_tanh(float x) {
    const float c = 0.7978845608028654f;
    return 0.5f * x * (1.f + tanhf(c * (x + 0.044715f * x * x * x)));
}
__device__ __forceinline__ float sigmoidf(float x) { return 1.f / (1.f + expf(-x)); }

__global__ void __launch_bounds__(256) rmsnorm_k(const float* __restrict__ in, const float* __restrict__ res, const float* __restrict__ g, float* __restrict__ out, float* __restrict__ ysum, int rows, int ncols) {
    const int wave = threadIdx.x >> 6, lane = threadIdx.x & 63;
    const int r = blockIdx.x * 4 + wave;
    if (r >= rows) return;
    const float* p = in + (size_t)r * ncols;
    const float* q = res ? res + (size_t)r * ncols : nullptr;
    float s = 0.f;
    for (int c = lane; c < ncols; c += 64) { float v = p[c] + (q ? q[c] : 0.f); s += v * v; }
    s = wave_sum(s);
    const float rr = rsqrtf(s / (float)ncols + EPS);
    for (int c = lane; c < ncols; c += 64) { float v = p[c] + (q ? q[c] : 0.f); if (ysum) ysum[(size_t)r * ncols + c] = v; out[(size_t)r * ncols + c] = v * rr * g[c]; }
}

__global__ void __launch_bounds__(256) sgemm_k(const float* __restrict__ A, int lda, const float* __restrict__ Bm, int ldb, float* __restrict__ C, int ldc, int K) {
    __shared__ float As[16][68];
    __shared__ float Bs[16][68];
    const int tid = threadIdx.x, tx = tid & 15, ty = tid >> 4;
    const int m0 = blockIdx.y * 64, n0 = blockIdx.x * 64;
    float acc[4][4];
#pragma unroll
    for (int i = 0; i < 4; ++i)
#pragma unroll
        for (int j = 0; j < 4; ++j) acc[i][j] = 0.f;
    for (int k0 = 0; k0 < K; k0 += 16) {
        const float4 a = *(const float4*)&A[(size_t)(m0 + (tid >> 2)) * lda + k0 + (tid & 3) * 4];
        As[(tid & 3) * 4 + 0][tid >> 2] = a.x; As[(tid & 3) * 4 + 1][tid >> 2] = a.y; As[(tid & 3) * 4 + 2][tid >> 2] = a.z; As[(tid & 3) * 4 + 3][tid >> 2] = a.w;
        const float4 b = *(const float4*)&Bm[(size_t)(k0 + (tid >> 4)) * ldb + n0 + (tid & 15) * 4];
        *(float4*)&Bs[tid >> 4][(tid & 15) * 4] = b;
        __syncthreads();
#pragma unroll
        for (int kk = 0; kk < 16; ++kk) {
            const float4 av = *(const float4*)&As[kk][ty * 4];
            const float4 bv = *(const float4*)&Bs[kk][tx * 4];
            const float aa[4] = {av.x, av.y, av.z, av.w}, bb[4] = {bv.x, bv.y, bv.z, bv.w};
#pragma unroll
            for (int i = 0; i < 4; ++i)
#pragma unroll
                for (int j = 0; j < 4; ++j) acc[i][j] += aa[i] * bb[j];
        }
        __syncthreads();
    }
#pragma unroll
    for (int i = 0; i < 4; ++i) {
        float4 o = {acc[i][0], acc[i][1], acc[i][2], acc[i][3]};
        *(float4*)&C[(size_t)(m0 + ty * 4 + i) * ldc + n0 + tx * 4] = o;
    }
}

__global__ void __launch_bounds__(256) sgu_norm_k(const float* __restrict__ proj, const float* __restrict__ g, float* __restrict__ vn) {
    const int wave = threadIdx.x >> 6, lane = threadIdx.x & 63;
    const int t = blockIdx.x * 4 + wave;
    const float* p = proj + (size_t)t * IN_DIM + AW;
    float v[8]; float s = 0.f;
#pragma unroll
    for (int i = 0; i < 8; ++i) { v[i] = gelu_tanh(p[lane + 64 * i]); s += v[i] * v[i]; }
    s = wave_sum(s);
    const float rr = rsqrtf(s / (float)AW + EPS);
#pragma unroll
    for (int i = 0; i < 8; ++i) vn[(size_t)t * AW + lane + 64 * i] = v[i] * rr * g[lane + 64 * i];
}
__global__ void __launch_bounds__(256) sgu_mix_k(const float* __restrict__ proj, const float* __restrict__ vn, const float* __restrict__ w_s, const float* __restrict__ b_s, float* __restrict__ ya) {
    const int idx = blockIdx.x * 256 + threadIdx.x;
    const int t = idx / AW, c = idx % AW, g = c / 128, tl = t % CH, cs = t - tl;
    const float* w = w_s + ((size_t)g * CH + tl) * CH;
    float acc = 0.f;
    for (int s = 0; s <= tl; ++s) acc += w[s] * vn[(size_t)(cs + s) * AW + c];
    acc += b_s[g * CH + tl];
    ya[(size_t)t * AW + c] = gelu_tanh(proj[(size_t)t * IN_DIM + c]) * acc;
}
__global__ void __launch_bounds__(256) attn_k(const float* __restrict__ proj, const float* __restrict__ sinks, const float* __restrict__ rel_bias, float* __restrict__ yb) {
    __shared__ float qs[4][64];
    const int wave = threadIdx.x >> 6, lane = threadIdx.x & 63;
    const int item = blockIdx.x * 4 + wave;
    const int t = item / NH, h = item % NH, kvh = h / 4;
    qs[wave][lane] = proj[(size_t)t * IN_DIM + 1024 + h * HD + lane];
    __syncthreads();
    float sc[2];
#pragma unroll
    for (int i = 0; i < 2; ++i) {
        const int dist = lane + 64 * i, kp = t - dist;
        if (kp >= 0) {
            const float* kr = proj + (size_t)kp * IN_DIM + 1536 + kvh * HD;
            float a = 0.f;
            for (int d = 0; d < HD; ++d) a += qs[wave][d] * kr[d];
            sc[i] = a * 0.125f + rel_bias[BUCKET[dist] * NH + h];
        } else sc[i] = -1e30f;
    }
    const float sink = sinks[h];
    float m = fmaxf(wave_max(fmaxf(sc[0], sc[1])), sink);
    float p0 = (t - lane >= 0) ? expf(sc[0] - m) : 0.f, p1 = (t - lane - 64 >= 0) ? expf(sc[1] - m) : 0.f;
    const float den = wave_sum(p0 + p1) + expf(sink - m);
    float o = 0.f;
    for (int j = 0; j < 128; ++j) {
        const float pj = __shfl(j < 64 ? p0 : p1, j & 63);
        const int kp = t - j;
        if (kp >= 0) o += pj * proj[(size_t)kp * IN_DIM + 1664 + kvh * HD + lane];
    }
    yb[(size_t)t * QD + h * HD + lane] = o / den;
}
__global__ void __launch_bounds__(256) merge_k(const float* __restrict__ proj, const float* __restrict__ pa, const float* __restrict__ pb, float* __restrict__ mg) {
    const int idx = blockIdx.x * 256 + threadIdx.x;
    const int t = idx / D, c = idx % D;
    const float ga = proj[(size_t)t * IN_DIM + 1792 + c], gb = proj[(size_t)t * IN_DIM + 2816 + c];
    mg[idx] = sigmoidf(ga) * pa[idx] + sigmoidf(gb) * pb[idx];
}
__global__ void __launch_bounds__(256) convgate_k(const float* __restrict__ up, const float* __restrict__ wc, const float* __restrict__ bc, float* __restrict__ hh) {
    const int idx = blockIdx.x * 256 + threadIdx.x;
    const int t = idx / DFF, f = idx % DFF;
    float cv[2];
#pragma unroll
    for (int i = 0; i < 2; ++i) {
        const int c = f + i * DFF;
        float y = wc[2 * 2 * DFF + c] * up[(size_t)t * 2 * DFF + c];
        if (t >= 1) y += wc[1 * 2 * DFF + c] * up[(size_t)(t - 1) * 2 * DFF + c];
        if (t >= 2) y += wc[0 * 2 * DFF + c] * up[(size_t)(t - 2) * 2 * DFF + c];
        cv[i] = y + bc[c];
    }
    hh[idx] = cv[0] * sigmoidf(cv[0]) * cv[1];
}
}

extern "C" void kernel_launch(void* const* d_in, const int* in_sizes, int n_in, void* d_out, int out_size, void* d_ws, size_t ws_size, hipStream_t stream) {
    const float* x = (const float*)d_in[0];
    const float* g_mix = (const float*)d_in[1];
    const float* w_in = (const float*)d_in[2];
    const float* g_sgu = (const float*)d_in[3];
    const float* w_s = (const float*)d_in[4];
    const float* b_s = (const float*)d_in[5];
    const float* sinks = (const float*)d_in[6];
    const float* rel_bias = (const float*)d_in[7];
    const float* w_pa = (const float*)d_in[8];
    const float* w_pb = (const float*)d_in[9];
    const float* w_out = (const float*)d_in[10];
    const float* g_ffn = (const float*)d_in[11];
    const float* w_up = (const float*)d_in[12];
    const float* w_conv = (const float*)d_in[13];
    const float* b_conv = (const float*)d_in[14];
    const float* w_down = (const float*)d_in[15];
    const float* g_final = (const float*)d_in[16];
    float* out = (float*)d_out;
    float* ws = (float*)d_ws;
    size_t off = 0;
    float* hn = ws + off; off += (size_t)S * D;
    float* proj = ws + off; off += (size_t)S * IN_DIM;
    float* vn = ws + off; off += (size_t)S * AW;
    float* ya = ws + off; off += (size_t)S * AW;
    float* yb = ws + off; off += (size_t)S * QD;
    float* pa = ws + off; off += (size_t)S * D;
    float* pb = ws + off; off += (size_t)S * D;
    float* mg = ws + off; off += (size_t)S * D;
    float* t1 = ws + off; off += (size_t)S * D;
    float* x1 = ws + off; off += (size_t)S * D;
    float* up = ws + off; off += (size_t)S * 2 * DFF;
    float* hh = ws + off; off += (size_t)S * DFF;
    if (off * sizeof(float) > ws_size) { fprintf(stderr, "workspace too small\n"); return; }
    for (int b = 0; b < NB; ++b) {
        const float* xb = x + (size_t)b * S * D;
        float* ob = out + (size_t)b * S * D;
        rmsnorm_k<<<S / 4, 256, 0, stream>>>(xb, nullptr, g_mix, hn, nullptr, S, D);
        sgemm_k<<<dim3(IN_DIM / 64, S / 64), 256, 0, stream>>>(hn, D, w_in, IN_DIM, proj, IN_DIM, D);
        sgu_norm_k<<<S / 4, 256, 0, stream>>>(proj, g_sgu, vn);
        sgu_mix_k<<<S * AW / 256, 256, 0, stream>>>(proj, vn, w_s, b_s, ya);
        attn_k<<<S * NH / 4, 256, 0, stream>>>(proj, sinks, rel_bias, yb);
        sgemm_k<<<dim3(D / 64, S / 64), 256, 0, stream>>>(ya, AW, w_pa, D, pa, D, AW);
        sgemm_k<<<dim3(D / 64, S / 64), 256, 0, stream>>>(yb, QD, w_pb, D, pb, D, QD);
        merge_k<<<S * D / 256, 256, 0, stream>>>(proj, pa, pb, mg);
        sgemm_k<<<dim3(D / 64, S / 64), 256, 0, stream>>>(mg, D, w_out, D, t1, D, D);
        rmsnorm_k<<<S / 4, 256, 0, stream>>>(t1, xb, g_ffn, hn, x1, S, D);
        sgemm_k<<<dim3(2 * DFF / 64, S / 64), 256, 0, stream>>>(hn, D, w_up, 2 * DFF, up, 2 * DFF, D);
        convgate_k<<<S * DFF / 256, 256, 0, stream>>>(up, w_conv, b_conv, hh);
        sgemm_k<<<dim3(D / 64, S / 64), 256, 0, stream>>>(hh, DFF, w_down, D, t1, D, DFF);
        rmsnorm_k<<<S / 4, 256, 0, stream>>>(t1, x1, g_final, ob, nullptr, S, D);
    }
}
```

```cpp
#include <hip/hip_runtime.h>
#include <cstdio>
#include <cstdint>

#define LAS __attribute__((address_space(3)))
#define GAS __attribute__((address_space(1)))
typedef unsigned short bf16_t;
typedef short bf16x8 __attribute__((ext_vector_type(8)));
typedef short s16x4 __attribute__((ext_vector_type(4)));
typedef float f32x4 __attribute__((ext_vector_type(4)));
typedef float f32x2 __attribute__((ext_vector_type(2)));
typedef float f32x16 __attribute__((ext_vector_type(16)));
typedef unsigned u32x4 __attribute__((ext_vector_type(4)));
typedef unsigned u32x2 __attribute__((ext_vector_type(2)));
typedef __bf16 bf16x2_t __attribute__((ext_vector_type(2)));

#ifndef MK_PHASE_MASK
#define MK_PHASE_MASK 0xff
#endif
#ifndef MK_N_LAUNCHES
#define MK_N_LAUNCHES 8
#endif

constexpr int T = 32768, DM = 1024, SEQ = 2048;
constexpr int IN_DIM = 3840, DFF = 2816, UPN = 5632;
constexpr float EPS = 1e-6f, LOG2E = 1.4426950408889634f;
constexpr float QSCALE = 0.125f * 1.4426950408889634f;
constexpr int NPHASE = 8;

__device__ const unsigned char BUCKET[128] = {0,1,2,3,4,5,6,7,8,9,10,11,12,13,14,15,16,16,16,17,17,18,18,18,19,19,19,20,20,20,20,21,21,21,21,22,22,22,22,22,23,23,23,23,23,23,24,24,24,24,24,24,25,25,25,25,25,25,25,26,26,26,26,26,26,26,26,27,27,27,27,27,27,27,27,27,27,28,28,28,28,28,28,28,28,28,28,29,29,29,29,29,29,29,29,29,29,29,29,30,30,30,30,30,30,30,30,30,30,30,30,30,30,31,31,31,31,31,31,31,31,31,31,31,31,31,31,31};

__device__ __forceinline__ unsigned cvtpk(float lo, float hi) { f32x2 v = {lo, hi}; bf16x2_t b = __builtin_convertvector(v, bf16x2_t); return __builtin_bit_cast(unsigned, b); }
__device__ __forceinline__ float bflo(unsigned w) { return __uint_as_float(w << 16); }
__device__ __forceinline__ float bfhi(unsigned w) { return __uint_as_float(w & 0xffff0000u); }
__device__ __forceinline__ float fast_sigmoid(float x) { return __builtin_amdgcn_rcpf(1.0f + __builtin_amdgcn_exp2f(-LOG2E * x)); }
__device__ __forceinline__ float gelu_tanh(float x) {
    const float z = x * (1.0f + 0.044715f * x * x);
    return x * __builtin_amdgcn_rcpf(1.0f + __builtin_amdgcn_exp2f(-2.0f * 0.7978845608028654f * LOG2E * z));
}
__device__ __forceinline__ float wave_sum(float v) {
#pragma unroll
    for (int o = 1; o < 64; o <<= 1) v += __shfl_xor(v, o);
    return v;
}
#define LDS_WAIT() asm volatile("s_waitcnt lgkmcnt(0)" ::: "memory")
#define VM_WAIT() asm volatile("s_waitcnt vmcnt(0)" ::: "memory")
#define RLX_AGENT __ATOMIC_RELAXED, __HIP_MEMORY_SCOPE_AGENT

namespace pg8 {
constexpr int BM = 256, BK = 64, HALF = 128, HTB = HALF * BK * 2, STAGE_BYTES = 8 * HTB, NXCD = 8, WGM = 8;
__host__ __device__ __forceinline__ int lds_byte(int r, int c) { const int st = (r >> 4) * 2 + (c >> 5), rr = r & 15, cc = c & 31, ob = rr * 64 + cc * 2; return st * 1024 + (ob ^ (((ob >> 9) & 1) << 5)); }
__host__ __device__ __forceinline__ void stage_rc(int b, int& R, int& C) { const int st = b / 1024, sb = b % 1024, swz = sb ^ (((sb >> 9) & 1) << 5); R = (st >> 1) * 16 + swz / 64; C = (st & 1) * 32 + (swz % 64) / 2; }
__host__ __device__ __forceinline__ int perm32(int rho) { const int n = rho >> 4, i = rho & 15; return 8 * (i >> 2) + 4 * n + (i & 3); }

struct Unit { int pm, pn; };
struct Gemm { const char* A; const char* Bt; size_t a_tstep, a_hstep, b_tstep, b_hstep; int K; };
struct MapNat { static __device__ __forceinline__ int rowA(int R) { return R; } };
struct MapConv { static __device__ __forceinline__ int rowA(int R) { return 8 * (16 * (R >> 6) + (R & 15)) + ((R >> 4) & 3); } };

struct StaticOrder {
    int nM, nN, nwg, G, c;
    __device__ void init(int M, int N, int G_, int c_) { nM = M / BM; nN = N / BM; nwg = nM * nN; G = G_; c = c_; }
    __device__ bool next(int i, Unit& u) const {
        const long L = (long)i * G + c; if (L >= nwg) return false;
        int wgid = (int)L; { const int q = nwg / NXCD, r = nwg % NXCD, xcd = wgid % NXCD, off = wgid / NXCD; wgid = (xcd < r ? xcd * (q + 1) : r * (q + 1) + (xcd - r) * q) + off; }
        const int nig = WGM * nN, gid = wgid / nig, fm = gid * WGM, gsz = (nM - fm) < WGM ? (nM - fm) : WGM;
        u.pm = fm + ((wgid % nig) % gsz); u.pn = (wgid % nig) / gsz; return true;
    }
};

typedef f32x4 Acc[2][2][4][2];

template <class Map, bool MIDHOOK, class Epi, class Sched>
__device__ __forceinline__ void gemm_phase(LAS unsigned char* lds, LAS unsigned char* side, const Gemm g, const Sched& S, const Epi& E) {
    const int tid = threadIdx.x, wid = __builtin_amdgcn_readfirstlane(tid >> 6), lane = tid & 63, wr = wid >> 2, wc = wid & 3, fr = lane & 15, fq = lane >> 4;
    const int K = g.K, nt = K / BK;
    unsigned voffA[2], voffB[2];
#pragma unroll
    for (int i = 0; i < 2; ++i) { int R, C; stage_rc(tid * 16 + i * 8192, R, C); const int Rb = (R & ~31) + perm32(R & 31);
        voffA[i] = (unsigned)(Map::rowA(R) * K + C) * 2u; voffB[i] = (unsigned)(Rb * K + C) * 2u; }
    const size_t kstep = (size_t)(BK * 2);
    const size_t hA = g.a_hstep, hB = g.b_hstep;
    const unsigned ldsw = (unsigned)wid * 1024u;
    const int aoff = lds_byte(wr * 64 + fr, fq * 8), boff = lds_byte(wc * 32 + fr, fq * 8);
#define PG8_SA(b, h) (((b) * 2 + (h)) * HTB)
#define PG8_SB(b, h) ((4 + (b) * 2 + (h)) * HTB)
#define PG8_STAGE(bufoff, gbase, voff) do { _Pragma("unroll") for (int _i = 0; _i < 2; ++_i) \
        __builtin_amdgcn_global_load_lds((const unsigned*)((const char*)(gbase) + (voff)[_i]), (LAS unsigned*)(lds + (bufoff) + ldsw + _i * 8192), 16, 0, 0); } while (0)
#define PG8_LDA(dst, b, h) do { _Pragma("unroll") for (int m = 0; m < 4; ++m) _Pragma("unroll") for (int k = 0; k < 2; ++k) dst[m][k] = *(const LAS bf16x8*)(lds + PG8_SA(b, h) + aoff + m * 2048 + k * 1024); } while (0)
#define PG8_LDB(dst, b, h) do { _Pragma("unroll") for (int n = 0; n < 2; ++n) _Pragma("unroll") for (int k = 0; k < 2; ++k) dst[n][k] = *(const LAS bf16x8*)(lds + PG8_SB(b, h) + boff + n * 2048 + k * 1024); } while (0)
#define PG8_MMA(ai, bj, At, Bt) do { __builtin_amdgcn_s_setprio(1); _Pragma("unroll") for (int m = 0; m < 4; ++m) _Pragma("unroll") for (int n = 0; n < 2; ++n) _Pragma("unroll") for (int k = 0; k < 2; ++k) \
        acc[ai][bj][m][n] = __builtin_amdgcn_mfma_f32_16x16x32_bf16(Bt[n][k], At[m][k], acc[ai][bj][m][n], 0, 0, 0); __builtin_amdgcn_s_setprio(0); } while (0)
#define PG8_WAIT_V(n) asm volatile("s_waitcnt vmcnt(" #n ")" ::: "memory")
#define PG8_WAIT_L(n) asm volatile("s_waitcnt lgkmcnt(" #n ")" ::: "memory")
#define PG8_BAR __builtin_amdgcn_s_barrier()
#define PG8_SCHED __builtin_amdgcn_sched_barrier(0)
    Unit cur, nxt; int ui = 0;
    if (!S.next(0, cur)) return;
    Acc acc;
#pragma unroll
    for (int a = 0; a < 2; ++a)
#pragma unroll
        for (int b = 0; b < 2; ++b)
#pragma unroll
            for (int m = 0; m < 4; ++m)
#pragma unroll
                for (int n = 0; n < 2; ++n) acc[a][b][m][n] = (f32x4){0.f, 0.f, 0.f, 0.f};
    bf16x8 At[4][2], B0[2][2], B1[2][2];
    const char* cA = g.A + (size_t)cur.pm * g.a_tstep; const char* cB = g.Bt + (size_t)cur.pn * g.b_tstep;
    PG8_STAGE(PG8_SB(0, 0), cB, voffB); PG8_STAGE(PG8_SB(0, 1), cB + hB, voffB); PG8_STAGE(PG8_SA(0, 0), cA, voffA); PG8_STAGE(PG8_SA(0, 1), cA + hA, voffA);
    if (wr == 1) PG8_BAR;
    PG8_WAIT_V(2); PG8_BAR;
    PG8_STAGE(PG8_SB(1, 0), cB + kstep, voffB); PG8_STAGE(PG8_SA(1, 0), cA + kstep, voffA); PG8_STAGE(PG8_SB(1, 1), cB + hB + kstep, voffB);
    PG8_WAIT_V(6); PG8_BAR;
    for (;;) {
        const bool has_next = S.next(ui + 1, nxt);
        const char* nA = has_next ? g.A + (size_t)nxt.pm * g.a_tstep : cA; const char* nB = has_next ? g.Bt + (size_t)nxt.pn * g.b_tstep : cB;
        const int nseg = MIDHOOK ? 2 : 1, seglen = nt / nseg;
        for (int sg = 0; sg < nseg; ++sg) {
        if constexpr (MIDHOOK) { if (sg == 1) E.mid(acc, cur, wr, wc, fr, fq); }
        for (int t = sg * seglen; t < (sg + 1) * seglen; t += 2) {
            const bool last = (t == nt - 2);
            const char* a1 = cA + (size_t)(t + 1) * kstep;
            const char* a2 = last ? nA : cA + (size_t)(t + 2) * kstep; const char* b2 = last ? nB : cB + (size_t)(t + 2) * kstep;
            const char* a3 = a2 + kstep; const char* b3 = b2 + kstep;
            PG8_LDB(B0, 0, 0); PG8_LDB(B1, 0, 1); PG8_SCHED; PG8_LDA(At, 0, 0); PG8_STAGE(PG8_SA(1, 1), a1 + hA, voffA);
            PG8_WAIT_V(8); PG8_WAIT_L(0); PG8_BAR; PG8_MMA(0, 0, At, B0); PG8_MMA(0, 1, At, B1); PG8_BAR; PG8_SCHED;
            PG8_LDA(At, 0, 1); PG8_STAGE(PG8_SB(0, 0), b2, voffB); PG8_STAGE(PG8_SB(0, 1), b2 + hB, voffB); PG8_STAGE(PG8_SA(0, 0), a2, voffA);
            PG8_WAIT_V(8); PG8_WAIT_L(0); PG8_BAR; PG8_MMA(1, 0, At, B0); PG8_MMA(1, 1, At, B1); PG8_BAR; PG8_SCHED;
            PG8_LDB(B0, 1, 0); PG8_LDB(B1, 1, 1); PG8_SCHED; PG8_LDA(At, 1, 0); PG8_STAGE(PG8_SA(0, 1), a2 + hA, voffA);
            PG8_WAIT_V(8); PG8_WAIT_L(0); PG8_BAR; PG8_MMA(0, 0, At, B0); PG8_MMA(0, 1, At, B1); PG8_BAR; PG8_SCHED;
            PG8_LDA(At, 1, 1); PG8_STAGE(PG8_SB(1, 0), b3, voffB); PG8_STAGE(PG8_SB(1, 1), b3 + hB, voffB); PG8_STAGE(PG8_SA(1, 0), a3, voffA);
            PG8_WAIT_V(8); PG8_WAIT_L(0); PG8_BAR; PG8_MMA(1, 0, At, B0); PG8_MMA(1, 1, At, B1); PG8_BAR; PG8_SCHED;
        }
        }
        if (wr == 0) PG8_BAR;
        E.epi(acc, cur, wr, wc, fr, fq, side, wid, lane);
        if (!has_next) break;
#pragma unroll
        for (int a = 0; a < 2; ++a)
#pragma unroll
            for (int b = 0; b < 2; ++b)
#pragma unroll
                for (int m = 0; m < 4; ++m)
#pragma unroll
                    for (int n = 0; n < 2; ++n) acc[a][b][m][n] = (f32x4){0.f, 0.f, 0.f, 0.f};
        cur = nxt; cA = nA; cB = nB; ++ui;
        if (wr == 1) PG8_BAR;
    }
    PG8_WAIT_V(0);
    PG8_BAR;
#undef PG8_SA
#undef PG8_SB
#undef PG8_STAGE
#undef PG8_LDA
#undef PG8_LDB
#undef PG8_MMA
#undef PG8_WAIT_V
#undef PG8_WAIT_L
#undef PG8_SCHED
}
#define EPI_BAR() do { asm volatile("s_waitcnt lgkmcnt(0)" ::: "memory"); __builtin_amdgcn_s_barrier(); asm volatile("" ::: "memory"); } while (0)

template <int ACT> __device__ __forceinline__ void store_bf16_tile(const Acc& acc, bf16_t* base, int ld, int colbase, int row0, int cw, float scale) {
#pragma unroll
    for (int ai = 0; ai < 2; ++ai)
#pragma unroll
        for (int m = 0; m < 4; ++m) { bf16_t* rowp = base + (size_t)(row0 + ai * HALF + m * 16) * ld + colbase + cw;
#pragma unroll
            for (int bj = 0; bj < 2; ++bj) { f32x4 v0 = acc[ai][bj][m][0], v1 = acc[ai][bj][m][1];
#pragma unroll
                for (int j = 0; j < 4; ++j) {
                    if (ACT == 0) { v0[j] *= scale; v1[j] *= scale; }
                    if (ACT == 1) { v0[j] = gelu_tanh(v0[j]); v1[j] = gelu_tanh(v1[j]); }
                    if (ACT == 2) { v0[j] = fast_sigmoid(v0[j]); v1[j] = fast_sigmoid(v1[j]); } }
                u32x4 w; w.x = cvtpk(v0[0], v0[1]); w.y = cvtpk(v0[2], v0[3]); w.z = cvtpk(v1[0], v1[1]); w.w = cvtpk(v1[2], v1[3]);
                *(u32x4*)(rowp + bj * HALF) = w; } }
}

struct EpiP1 {
    bf16_t *U, *VV, *Q, *KV, *GA, *GB; float* VSS;
    __device__ __forceinline__ void epi(Acc& acc, const Unit& u, int wr, int wc, int fr, int fq, LAS unsigned char*, int, int) const {
        const int pn = u.pn; int row0 = u.pm * BM + wr * 64 + fr, cw = wc * 32 + 8 * fq;
        asm volatile("" : "+v"(row0), "+v"(cw));
        bf16_t* base; int ld, colbase, act; float scale = 1.f;
        if (pn < 2) { base = U; ld = 512; colbase = 256 * pn; act = 1; }
        else if (pn < 4) { base = VV; ld = 512; colbase = 256 * (pn - 2); act = 3; }
        else if (pn < 6) { base = Q; ld = 512; colbase = 256 * (pn - 4); act = 0; scale = QSCALE; }
        else if (pn == 6) { base = KV; ld = 256; colbase = 0; act = 0; }
        else if (pn < 11) { base = GA; ld = 1024; colbase = 256 * (pn - 7); act = 2; }
        else { base = GB; ld = 1024; colbase = 256 * (pn - 11); act = 2; }
        base += colbase + cw;
#pragma unroll
        for (int ai = 0; ai < 2; ++ai)
#pragma unroll
            for (int m = 0; m < 4; ++m) { const int row = row0 + ai * HALF + m * 16; bf16_t* rowp = base + (size_t)row * ld; float s = 0.f;
#pragma unroll
                for (int bj = 0; bj < 2; ++bj) { f32x4 v0 = acc[ai][bj][m][0], v1 = acc[ai][bj][m][1];
                    if (act == 0) { v0 *= scale; v1 *= scale; }
                    else if (act == 2) {
#pragma unroll
                        for (int j = 0; j < 4; ++j) { v0[j] = fast_sigmoid(v0[j]); v1[j] = fast_sigmoid(v1[j]); } }
                    else {
#pragma unroll
                        for (int j = 0; j < 4; ++j) { v0[j] = gelu_tanh(v0[j]); v1[j] = gelu_tanh(v1[j]); s += v0[j] * v0[j] + v1[j] * v1[j]; } }
                    u32x4 w; w.x = cvtpk(v0[0], v0[1]); w.y = cvtpk(v0[2], v0[3]); w.z = cvtpk(v1[0], v1[1]); w.w = cvtpk(v1[2], v1[3]);
                    *(u32x4*)(rowp + bj * HALF) = w; }
                if (act == 3) { s += __shfl_xor(s, 16); s += __shfl_xor(s, 32); if (fq == 0) VSS[(size_t)row * 8 + (pn - 2) * 4 + wc] = s; }
                asm volatile("" ::: "memory"); }
    }
};

struct EpiP3 {
    const bf16_t *GA, *GB; bf16_t* MG;
    __device__ __forceinline__ void mid(Acc& acc, const Unit& u, int wr, int wc, int fr, int fq) const {
        int row0 = u.pm * BM + wr * 64 + fr, col0 = u.pn * BM + wc * 32 + 8 * fq;
        asm volatile("" : "+v"(row0), "+v"(col0));
#pragma unroll
        for (int ai = 0; ai < 2; ++ai)
#pragma unroll
            for (int mh = 0; mh < 2; ++mh) {
                u32x4 a[2][2], b[2][2];
#pragma unroll
                for (int mm = 0; mm < 2; ++mm)
#pragma unroll
                    for (int bj = 0; bj < 2; ++bj) { const size_t off = (size_t)(row0 + ai * HALF + (2 * mh + mm) * 16) * 1024 + col0 + bj * HALF; a[mm][bj] = *(const u32x4*)(GA + off); b[mm][bj] = *(const u32x4*)(GB + off); }
#pragma unroll
                for (int mm = 0; mm < 2; ++mm)
#pragma unroll
                    for (int bj = 0; bj < 2; ++bj) { const u32x4 aa = a[mm][bj], bb = b[mm][bj]; f32x4 r0, r1;
                        r0[0] = bflo(bb.x) * __builtin_amdgcn_rcpf(bflo(aa.x)); r0[1] = bfhi(bb.x) * __builtin_amdgcn_rcpf(bfhi(aa.x)); r0[2] = bflo(bb.y) * __builtin_amdgcn_rcpf(bflo(aa.y)); r0[3] = bfhi(bb.y) * __builtin_amdgcn_rcpf(bfhi(aa.y));
                        r1[0] = bflo(bb.z) * __builtin_amdgcn_rcpf(bflo(aa.z)); r1[1] = bfhi(bb.z) * __builtin_amdgcn_rcpf(bfhi(aa.z)); r1[2] = bflo(bb.w) * __builtin_amdgcn_rcpf(bflo(aa.w)); r1[3] = bfhi(bb.w) * __builtin_amdgcn_rcpf(bfhi(aa.w));
                        acc[ai][bj][2 * mh + mm][0] *= r0; acc[ai][bj][2 * mh + mm][1] *= r1; }
                asm volatile("" ::: "memory"); }
    }
    __device__ __forceinline__ void epi(Acc& acc, const Unit& u, int wr, int wc, int fr, int fq, LAS unsigned char*, int, int) const {
        int row0 = u.pm * BM + wr * 64 + fr, col0 = u.pn * BM + wc * 32 + 8 * fq;
        asm volatile("" : "+v"(row0), "+v"(col0));
#pragma unroll
        for (int ai = 0; ai < 2; ++ai)
#pragma unroll
            for (int m = 0; m < 4; ++m) { const size_t off = (size_t)(row0 + ai * HALF + m * 16) * 1024 + col0;
#pragma unroll
                for (int bj = 0; bj < 2; ++bj) { const u32x4 a = *(const u32x4*)(GA + off + bj * HALF);
                    const f32x4 v0 = acc[ai][bj][m][0], v1 = acc[ai][bj][m][1];
                    u32x4 w; w.x = cvtpk(v0[0] * bflo(a.x), v0[1] * bfhi(a.x)); w.y = cvtpk(v0[2] * bflo(a.y), v0[3] * bfhi(a.y));
                    w.z = cvtpk(v1[0] * bflo(a.z), v1[1] * bfhi(a.z)); w.w = cvtpk(v1[2] * bflo(a.w), v1[3] * bfhi(a.w));
                    *(u32x4*)(MG + off + bj * HALF) = w; } }
    }
};

template <bool WRITE_BF16> struct EpiRes {
    const float* base; float* out; bf16_t* xb; float* SS;
    __device__ __forceinline__ void epi(Acc& acc, const Unit& u, int wr, int wc, int fr, int fq, LAS unsigned char* side, int wid, int lane) const {
        int row0 = u.pm * BM + wr * 64 + fr, col0 = u.pn * BM + wc * 32 + 8 * fq;
        asm volatile("" : "+v"(row0), "+v"(col0));
        LAS float* red = (LAS float*)side;
#pragma unroll
        for (int ai = 0; ai < 2; ++ai)
#pragma unroll
            for (int m = 0; m < 4; ++m) { const int rl = ai * HALF + wr * 64 + m * 16 + fr; const size_t off = (size_t)(row0 + ai * HALF + m * 16) * 1024 + col0; float s = 0.f;
#pragma unroll
                for (int bj = 0; bj < 2; ++bj) {
                    const f32x4 b0 = *(const f32x4*)(base + off + bj * HALF), b1 = *(const f32x4*)(base + off + bj * HALF + 4);
                    const f32x4 v0 = acc[ai][bj][m][0] + b0, v1 = acc[ai][bj][m][1] + b1;
                    s += (v0[0] * v0[0] + v0[1] * v0[1]) + (v0[2] * v0[2] + v0[3] * v0[3]) + (v1[0] * v1[0] + v1[1] * v1[1]) + (v1[2] * v1[2] + v1[3] * v1[3]);
                    *(f32x4*)(out + off + bj * HALF) = v0; *(f32x4*)(out + off + bj * HALF + 4) = v1;
                    if (WRITE_BF16) { u32x4 w; w.x = cvtpk(v0[0], v0[1]); w.y = cvtpk(v0[2], v0[3]); w.z = cvtpk(v1[0], v1[1]); w.w = cvtpk(v1[2], v1[3]); *(u32x4*)(xb + off + bj * HALF) = w; } }
                s += __shfl_xor(s, 16); s += __shfl_xor(s, 32);
                if (fq == 0) red[rl * 4 + wc] = s; }
        EPI_BAR();
        const int tid = wid * 64 + lane;
        if (tid < 256) { const f32x4 p = *(const LAS f32x4*)(red + tid * 4); SS[(size_t)(u.pm * BM + tid) * 4 + u.pn] = (p[0] + p[1]) + (p[2] + p[3]); }
        EPI_BAR();
    }
};

constexpr unsigned HALO_TAG = 0x5EED0001u;
struct EpiP5 {
    const float* SS1; const float* wconv; const float* bconv; bf16_t* H; unsigned long long* GH; unsigned* tmo;
    __device__ __forceinline__ void epi(Acc& acc, const Unit& u, int wr, int wc, int fr, int fq, LAS unsigned char* side, int wid, int lane) const {
        int tok0 = u.pm * BM + 8 * (16 * wr + fr);
        int cl = wc * 32 + 8 * fq;
        asm volatile("" : "+v"(tok0), "+v"(cl));
        float rk[8];
#pragma unroll
        for (int k = 0; k < 8; ++k) { const f32x4 p = *(const f32x4*)(SS1 + (size_t)(tok0 + k) * 4); rk[k] = __builtin_amdgcn_rsqf(((p[0] + p[1]) + (p[2] + p[3])) * (1.0f / 1024.0f) + EPS); }
#pragma unroll
        for (int ai = 0; ai < 2; ++ai)
#pragma unroll
            for (int m = 0; m < 4; ++m)
#pragma unroll
                for (int bj = 0; bj < 2; ++bj)
#pragma unroll
                    for (int n = 0; n < 2; ++n) acc[ai][bj][m][n] *= rk[4 * ai + m];
        LAS float* X = (LAS float*)side + 4096;
        LAS float* myX = X + ((wr * 4 + wc) * 4 + fq) * 32;
        const bool seq_first = (u.pm & 7) == 0, seq_last = (u.pm & 7) == 7;
        if (fr == 15) {
            if (wr == 0) {
                LAS float* dst = X + ((4 + wc) * 4 + fq) * 32;
#pragma unroll
                for (int kk = 0; kk < 2; ++kk)
#pragma unroll
                    for (int bj = 0; bj < 2; ++bj)
#pragma unroll
                        for (int n = 0; n < 2; ++n) *(LAS f32x4*)(dst + kk * 16 + bj * 8 + n * 4) = acc[1][bj][2 + kk][n];
            } else if (!seq_last) {
                unsigned long long* gp = GH + ((size_t)(u.pm * 22 + u.pn) * 2) * 256 + cl;
#pragma unroll
                for (int kk = 0; kk < 2; ++kk)
#pragma unroll
                    for (int bj = 0; bj < 2; ++bj)
#pragma unroll
                        for (int n = 0; n < 2; ++n)
#pragma unroll
                            for (int j = 0; j < 4; ++j)
                                __hip_atomic_store(gp + kk * 256 + bj * 128 + n * 4 + j, ((unsigned long long)HALO_TAG << 32) | (unsigned long long)__float_as_uint(acc[1][bj][2 + kk][n][j]), RLX_AGENT);
            }
        }
        if (wr == 0) {
            if (seq_first) {
                if (fr == 0) {
#pragma unroll
                    for (int i = 0; i < 8; ++i) *(LAS f32x4*)(myX + 4 * i) = (f32x4){0.f, 0.f, 0.f, 0.f}; }
            } else {
                const unsigned long long* gp = GH + ((size_t)((u.pm - 1) * 22 + u.pn) * 2) * 256 + cl;
                const bool act = (fr == 0);
                unsigned spins = 0;
                for (;;) {
                    bool ok = true;
                    if (act) {
#pragma unroll
                        for (int kk = 0; kk < 2; ++kk)
#pragma unroll
                            for (int bj = 0; bj < 2; ++bj) {
                                unsigned long long w[8];
#pragma unroll
                                for (int i = 0; i < 8; ++i) w[i] = __hip_atomic_load(gp + kk * 256 + bj * 128 + i, RLX_AGENT);
#pragma unroll
                                for (int i = 0; i < 8; ++i) { ok = ok && ((unsigned)(w[i] >> 32) == HALO_TAG); myX[kk * 16 + bj * 8 + i] = __uint_as_float((unsigned)w[i]); }
                                asm volatile("" ::: "memory"); }
                    }
                    if (__all(ok)) break;
                    if (++spins > (1u << 16)) { if (lane == 0) __hip_atomic_store(tmo, 0x500u | (unsigned)u.pn, RLX_AGENT); break; }
                    __builtin_amdgcn_s_sleep(4);
                }
            }
        }
        EPI_BAR();
        const int fcol = u.pn * 128 + cl;
        unsigned hp0[8][2];
#pragma unroll
        for (int n = 0; n < 2; ++n) {
#pragma unroll
            for (int bj = 0; bj < 2; ++bj) {
                const int c = bj * DFF + fcol + 4 * n;
                const f32x4 w0 = *(const f32x4*)(wconv + c), w1 = *(const f32x4*)(wconv + UPN + c), w2 = *(const f32x4*)(wconv + 2 * UPN + c), bb = *(const f32x4*)(bconv + c);
                f32x4 a2 = *(const LAS f32x4*)(myX + bj * 8 + n * 4), a1 = *(const LAS f32x4*)(myX + 16 + bj * 8 + n * 4);
#pragma unroll
                for (int j = 0; j < 4; ++j) {
                    a2[j] = __int_as_float(__builtin_amdgcn_update_dpp(__float_as_int(a2[j]), __float_as_int(acc[1][bj][2][n][j]), 0x111, 0xf, 0xf, false));
                    a1[j] = __int_as_float(__builtin_amdgcn_update_dpp(__float_as_int(a1[j]), __float_as_int(acc[1][bj][3][n][j]), 0x111, 0xf, 0xf, false)); }
#pragma unroll
                for (int k = 0; k < 8; ++k) {
                    const f32x4 a0 = acc[k >> 2][bj][k & 3][n];
                    f32x4 y = w2 * a0 + w1 * a1 + w0 * a2 + bb; a2 = a1; a1 = a0;
                    if (bj == 0) {
#pragma unroll
                        for (int j = 0; j < 4; ++j) y[j] = y[j] * fast_sigmoid(y[j]);
                        acc[k >> 2][0][k & 3][n] = y;
                    } else {
                        const f32x4 gsl = acc[k >> 2][0][k & 3][n];
                        const unsigned lo = cvtpk(y[0] * gsl[0], y[1] * gsl[1]), hi2 = cvtpk(y[2] * gsl[2], y[3] * gsl[3]);
                        if (n == 0) { hp0[k][0] = lo; hp0[k][1] = hi2; }
                        else { u32x4 w; w.x = hp0[k][0]; w.y = hp0[k][1]; w.z = lo; w.w = hi2; *(u32x4*)(H + (size_t)(tok0 + k) * DFF + fcol) = w; }
                    }
                }
                asm volatile("" ::: "memory");
            }
        }
    }
};
}

constexpr size_t MiB = 1u << 20;
constexpr size_t WS_CTL = 0, CTL_ZERO_BYTES = 1 * MiB;
constexpr size_t WS_WIN = 1 * MiB;
constexpr size_t WS_WP = 9 * MiB;
constexpr size_t WS_WOUT = 11 * MiB;
constexpr size_t WS_WUP = 13 * MiB;
constexpr size_t WS_WDN = 24 * MiB;
constexpr size_t WS_VSS = 30 * MiB;
constexpr size_t WS_SS1 = 31 * MiB;
constexpr size_t WS_SS2 = 31 * MiB + 512 * 1024;
constexpr size_t WS_GH = 32 * MiB;
constexpr size_t WS_XN = 44 * MiB;
constexpr size_t WS_MG = 108 * MiB;
constexpr size_t WS_U = 172 * MiB;
constexpr size_t WS_VV = 204 * MiB;
constexpr size_t WS_Q = 236 * MiB;
constexpr size_t WS_KV = 268 * MiB;
constexpr size_t WS_GA = 284 * MiB;
constexpr size_t WS_GB = 348 * MiB;
constexpr size_t WS_Y = 412 * MiB;
constexpr size_t WS_END = 476 * MiB;
constexpr size_t WS_H = 172 * MiB;
static_assert(WS_H + (size_t)T * DFF * 2 <= WS_END, "h overlay");
constexpr int CW_TMO = 0, CW_BAR = 4096;

constexpr int RING_BYTES = 131072, SIDE_OFF = 131072, SIDE_BYTES = 24576, LDSCTL_OFF = SIDE_OFF + SIDE_BYTES, LDS_BYTES = LDSCTL_OFF + 512;

#define XB_TMO      128
#define XB_XCNT(j)  (256  + 64 * (j))
#define XB_XSUB(j)  (1280 + 64 * (j))
#define XB_XGEN(j)  (2304 + 64 * (j))
#define XB_TOP      3328
#define XB_TOPGEN   3392
#define XCD_BAR_WORDS 3456
#define XB_SPIN_CAP (1u << 18)
__device__ __forceinline__ unsigned xb_ld(unsigned* p)              { return __hip_atomic_load(p, __ATOMIC_RELAXED, __HIP_MEMORY_SCOPE_AGENT); }
__device__ __forceinline__ unsigned xb_add(unsigned* p, unsigned v) { return __hip_atomic_fetch_add(p, v, __ATOMIC_RELAXED, __HIP_MEMORY_SCOPE_AGENT); }
__device__ __forceinline__ unsigned xb_xcc_id() { return (unsigned)__builtin_amdgcn_s_getreg((3 << 11) | 20) & 0xFu; }
#define XB_SPIN(cond, bar) do { unsigned _sp = 0; while (cond) { __builtin_amdgcn_s_sleep(1); \
    if ((++_sp & 255u) == 0u) { if (xb_ld(&(bar)[XB_TMO])) break; if (_sp > XB_SPIN_CAP) { atomicAdd(&(bar)[XB_TMO], 1u); break; } } } } while (0)
struct XcdBarrier { unsigned* bar; unsigned x; volatile LAS unsigned* st; };
__device__ __forceinline__ XcdBarrier xcd_barrier_post(unsigned* bar, volatile LAS unsigned* st) {
    XcdBarrier b; b.bar = bar; b.x = xb_xcc_id(); b.st = st;
    if (threadIdx.x == 0) (void)xb_add(&bar[XB_XCNT(b.x)], 1u);
    return b;
}
__device__ __forceinline__ void xcd_barrier_complete(unsigned* bar, unsigned x, unsigned& nloc, unsigned& nx) {
    const unsigned G = gridDim.x * gridDim.y * gridDim.z;
    unsigned sum, cnt, mine, sp = 0u;
    for (;;) {
        sum = 0u; cnt = 0u; mine = 0u;
#pragma unroll
        for (unsigned j = 0; j < 16; ++j) { const unsigned c = xb_ld(&bar[XB_XCNT(j)]); sum += c; cnt += (c > 0u) ? 1u : 0u; mine = (j == x) ? c : mine; }
        if (sum == G) break;
        __builtin_amdgcn_s_sleep(1);
        if ((++sp & 255u) == 0u) { if (xb_ld(&bar[XB_TMO])) break; if (sp > XB_SPIN_CAP) { atomicAdd(&bar[XB_TMO], 1u); break; } }
    }
    nloc = mine > 0u ? mine : 1u; nx = cnt > 0u ? cnt : 1u;
}
__device__ __forceinline__ void xcd_barrier(const XcdBarrier& b) {
    asm volatile("s_waitcnt vmcnt(0)" ::: "memory");
    __syncthreads();
    if (threadIdx.x == 0) {
        unsigned* bar = b.bar;
        __builtin_amdgcn_s_waitcnt(0);
        unsigned nloc = b.st[0], nx = b.st[1];
        if (nloc == 0u) { xcd_barrier_complete(bar, b.x, nloc, nx); b.st[0] = nloc; b.st[1] = nx; }
        const unsigned old = xb_add(&bar[XB_XSUB(b.x)], 1u);
        const unsigned gen = old / nloc;
        if (old + 1u == (gen + 1u) * nloc) {
            __builtin_amdgcn_fence(__ATOMIC_RELEASE, "agent");
            asm volatile("s_waitcnt vmcnt(0)" ::: "memory");
            const unsigned og = xb_add(&bar[XB_TOP], 1u);
            const unsigned tg = og / nx;
            if (og + 1u == (tg + 1u) * nx) xb_add(&bar[XB_TOPGEN], 1u);
            else XB_SPIN(xb_ld(&bar[XB_TOPGEN]) == tg, bar);
            __builtin_amdgcn_fence(__ATOMIC_ACQUIRE, "agent");
            xb_add(&bar[XB_XGEN(b.x)], 1u);
            asm volatile("s_waitcnt vmcnt(0)" ::: "memory");
        } else {
            XB_SPIN(xb_ld(&bar[XB_XGEN(b.x)]) == gen, bar);
            __builtin_amdgcn_fence(__ATOMIC_ACQUIRE, "agent");
            asm volatile("s_waitcnt vmcnt(0)" ::: "memory");
        }
    }
    __syncthreads();
}

struct Frame {
    LAS unsigned char* lds;
    int tid, lane, wave, vcu, G;
    const float *x, *g_mix, *w_in, *g_sgu, *w_s, *b_s, *sinks, *rel_bias, *w_pa, *w_pb, *w_out, *g_ffn, *w_up, *w_conv, *b_conv, *w_down, *g_final;
    float* out; unsigned char* ws;
};

__device__ __forceinline__ unsigned f2bf(float f) { unsigned u = __builtin_bit_cast(unsigned, f); return (u + 0x7fffu + ((u >> 16) & 1u)) >> 16; }
__device__ __forceinline__ unsigned pk2(float lo, float hi) { return f2bf(lo) | (f2bf(hi) << 16); }
template <int MODE  > __device__ __forceinline__ void p0_transpose_item(const float* W, int K, int N, bf16_t* WT, int ldt, int koff, const float* kscale, LAS float* scr, int item, int lane) {
    const int nblk = N / 32, kb = item / nblk, nb = item % nblk, k0 = 64 * kb, n0 = 32 * nb;
#pragma unroll 8
    for (int i = 0; i < 32; ++i) { const int kk = 2 * i + (lane >> 5); float v = W[(size_t)(k0 + kk) * N + n0 + (lane & 31)]; if (kscale) v *= kscale[k0 + kk]; scr[kk * 33 + (lane & 31)] = v; }
    LDS_WAIT(); asm volatile("" ::: "memory");
    const int c = lane & 7;
    int r0 = n0;
    if (MODE == 1) { const int half = n0 >= DFF ? 1 : 0, nn = n0 - half * DFF; r0 = (nn >> 7) * 256 + half * 128 + (nn & 127); }
#pragma unroll
    for (int j = 0; j < 4; ++j) { const int n = (lane >> 3) + 8 * j; const LAS float* s = scr + (8 * c) * 33 + n;
        u32x4 o; o.x = pk2(s[0 * 33], s[1 * 33]); o.y = pk2(s[2 * 33], s[3 * 33]); o.z = pk2(s[4 * 33], s[5 * 33]); o.w = pk2(s[6 * 33], s[7 * 33]);
        *(GAS u32x4*)(WT + (size_t)(r0 + n) * ldt + koff + k0 + 8 * c) = o; }
    LDS_WAIT(); asm volatile("" ::: "memory");
}
__device__ __forceinline__ void p0_prologue(Frame& F) {
    LAS float* scr = (LAS float*)(F.lds + F.wave * 16384);
    const int gw = F.vcu * 8 + F.wave, NGW = F.G * 8;
    bf16_t* Win_t = (bf16_t*)(F.ws + WS_WIN); bf16_t* Wp_t = (bf16_t*)(F.ws + WS_WP); bf16_t* Wout_t = (bf16_t*)(F.ws + WS_WOUT); bf16_t* Wup_t = (bf16_t*)(F.ws + WS_WUP); bf16_t* Wdn_t = (bf16_t*)(F.ws + WS_WDN);
    constexpr int I_IN = (1024 / 64) * (IN_DIM / 32), I_PB = (512 / 64) * (1024 / 32), I_PA = I_PB, I_OUT = (1024 / 64) * (1024 / 32), I_UP = (1024 / 64) * (UPN / 32), I_DN = (DFF / 64) * (1024 / 32);
    constexpr int NITEMS = I_IN + I_PB + I_PA + I_OUT + I_UP + I_DN;
    for (int it = gw; it < NITEMS; it += NGW) {
        int r = it;
        if (r < I_IN) { p0_transpose_item<0>(F.w_in, 1024, IN_DIM, Win_t, 1024, 0, nullptr, scr, r, F.lane); continue; } r -= I_IN;
        if (r < I_PB) { p0_transpose_item<0>(F.w_pb, 512, 1024, Wp_t, 1024, 0, nullptr, scr, r, F.lane); continue; } r -= I_PB;
        if (r < I_PA) { p0_transpose_item<0>(F.w_pa, 512, 1024, Wp_t, 1024, 512, nullptr, scr, r, F.lane); continue; } r -= I_PA;
        if (r < I_OUT) { p0_transpose_item<0>(F.w_out, 1024, 1024, Wout_t, 1024, 0, nullptr, scr, r, F.lane); continue; } r -= I_OUT;
        if (r < I_UP) { p0_transpose_item<1>(F.w_up, 1024, UPN, Wup_t, 1024, 0, F.g_ffn, scr, r, F.lane); continue; } r -= I_UP;
        p0_transpose_item<0>(F.w_down, DFF, 1024, Wdn_t, DFF, 0, nullptr, scr, r, F.lane);
    }
    bf16_t* XN = (bf16_t*)(F.ws + WS_XN);
    f32x4 gm[4];
#pragma unroll
    for (int j = 0; j < 4; ++j) gm[j] = *((const f32x4*)F.g_mix + F.lane + 64 * j);
    for (int m = gw; m < T; m += NGW) {
        const GAS f32x4* xr = (const GAS f32x4*)(F.x + (size_t)m * DM) + F.lane;
        f32x4 v[4]; float s = 0.f;
#pragma unroll
        for (int j = 0; j < 4; ++j) { v[j] = xr[64 * j]; s += (v[j].x * v[j].x + v[j].y * v[j].y) + (v[j].z * v[j].z + v[j].w * v[j].w); }
        const float r = __builtin_amdgcn_rsqf(wave_sum(s) * (1.f / DM) + EPS);
        GAS u32x2* o8 = (GAS u32x2*)(XN + (size_t)m * DM) + F.lane;
#pragma unroll
        for (int j = 0; j < 4; ++j) { u32x2 w; w.x = cvtpk(v[j].x * r * gm[j].x, v[j].y * r * gm[j].y); w.y = cvtpk(v[j].z * r * gm[j].z, v[j].w * r * gm[j].w); o8[64 * j] = w; }
    }
    { u32x4* gh = (u32x4*)(F.ws + WS_GH); const size_t n16 = (size_t)128 * 22 * 2 * 256 * 8 / 16;
      for (size_t i = (size_t)F.vcu * 512 + F.tid; i < n16; i += (size_t)F.G * 512) gh[i] = (u32x4){0u, 0u, 0u, 0u}; }
}

constexpr int SG_VSB = 272;
__device__ __forceinline__ s16x4 tr16(const LAS unsigned char* p) { return __builtin_bit_cast(s16x4, __builtin_amdgcn_ds_read_tr16_b64_v4i16((LAS s16x4*)p)); }
__device__ __forceinline__ void sgu_unit(Frame& F, int cidx) {
    LAS unsigned char* lds = F.lds;
    LAS float* rS = (LAS float*)lds;
    LAS unsigned char* vvT = lds + 1024;
    LAS unsigned char* uT = lds + 1024 + 128 * SG_VSB;
    const bf16_t* U = (const bf16_t*)(F.ws + WS_U); const bf16_t* VV = (const bf16_t*)(F.ws + WS_VV); const float* VSS = (const float*)(F.ws + WS_VSS); bf16_t* Y = (bf16_t*)(F.ws + WS_Y);
    const int tok0 = cidx * 128, tid = F.tid, lane = F.lane, w = F.wave, i16 = lane & 15, g4 = lane >> 4;
    if (tid < 128) { const f32x4 a = *(const f32x4*)(VSS + (size_t)(tok0 + tid) * 8), b = *(const f32x4*)(VSS + (size_t)(tok0 + tid) * 8 + 4);
        rS[tid] = __builtin_amdgcn_rsqf((((a[0] + a[1]) + (a[2] + a[3])) + ((b[0] + b[1]) + (b[2] + b[3]))) * (1.0f / 512.0f) + EPS); }
    for (int g = 0; g < 4; ++g) {
#pragma unroll
        for (int i = 0; i < 4; ++i) { const int idx = tid + 512 * i, row = idx >> 4, ch = idx & 15;
            const u32x4 a = *(const u32x4*)(VV + (size_t)(tok0 + row) * 512 + 128 * g + ch * 8), b = *(const u32x4*)(U + (size_t)(tok0 + row) * 512 + 128 * g + ch * 8);
            *(LAS u32x4*)(vvT + row * SG_VSB + ch * 16) = a; *(LAS u32x4*)(uT + row * SG_VSB + ch * 16) = b; }
        LDS_WAIT(); __syncthreads();
        const int t = 16 * w + i16, nks = (w >> 1) + 1;
        f32x4 acc[8];
#pragma unroll
        for (int nb = 0; nb < 8; ++nb) acc[nb] = (f32x4){0.f, 0.f, 0.f, 0.f};
        for (int ks = 0; ks < nks; ++ks) {
            const int s0 = 32 * ks + 8 * g4;
            const float* wp = F.w_s + ((size_t)g * 128 + t) * 128 + s0;
            const f32x4 wa = *(const f32x4*)wp, wb = *(const f32x4*)(wp + 4);
            const f32x4 ra = *(const LAS f32x4*)(rS + s0), rb = *(const LAS f32x4*)(rS + s0 + 4);
            float wv[8];
#pragma unroll
            for (int j = 0; j < 4; ++j) { wv[j] = (s0 + j <= t) ? wa[j] * ra[j] : 0.f; wv[4 + j] = (s0 + 4 + j <= t) ? wb[j] * rb[j] : 0.f; }
            u32x4 wf; wf.x = cvtpk(wv[0], wv[1]); wf.y = cvtpk(wv[2], wv[3]); wf.z = cvtpk(wv[4], wv[5]); wf.w = cvtpk(wv[6], wv[7]);
            const bf16x8 wfrag = __builtin_bit_cast(bf16x8, wf);
            const LAS unsigned char* vb = vvT + (32 * ks + 8 * g4 + (i16 >> 2)) * SG_VSB + (i16 & 3) * 8;
#pragma unroll
            for (int nb = 0; nb < 8; ++nb) {
                const s16x4 lo = tr16(vb + nb * 32), hi = tr16(vb + 4 * SG_VSB + nb * 32);
                const bf16x8 vf = {lo[0], lo[1], lo[2], lo[3], hi[0], hi[1], hi[2], hi[3]};
                acc[nb] = __builtin_amdgcn_mfma_f32_16x16x32_bf16(vf, wfrag, acc[nb], 0, 0, 0);
            }
        }
        const float bs = F.b_s[g * 128 + t];
#pragma unroll
        for (int nb = 0; nb < 8; ++nb) {
            const int d = 16 * nb + 4 * g4;
            const f32x4 gs = *(const f32x4*)(F.g_sgu + 128 * g + d);
            LAS u32x2* up = (LAS u32x2*)(uT + t * SG_VSB + d * 2);
            const u32x2 uu = *up;
            u32x2 o; o.x = cvtpk(bflo(uu.x) * (gs[0] * acc[nb][0] + bs), bfhi(uu.x) * (gs[1] * acc[nb][1] + bs)); o.y = cvtpk(bflo(uu.y) * (gs[2] * acc[nb][2] + bs), bfhi(uu.y) * (gs[3] * acc[nb][3] + bs));
            *up = o;
        }
        LDS_WAIT(); __syncthreads();
#pragma unroll
        for (int i = 0; i < 4; ++i) { const int idx = tid + 512 * i, row = idx >> 4, ch = idx & 15;
            *(u32x4*)(Y + (size_t)(tok0 + row) * 1024 + 512 + 128 * g + ch * 8) = *(const LAS u32x4*)(uT + row * SG_VSB + ch * 16); }
        LDS_WAIT(); __syncthreads();
    }
}

__device__ __forceinline__ int crow(int r, int hi) { return (r & 3) + 8 * (r >> 2) + 4 * hi; }
constexpr int AT_K = 0, AT_V = 32768, AT_TAB = 65536, AT_WS = 67584, AT_OST = 69632;
__device__ __forceinline__ void attn_unit(Frame& F, int item) {
    LAS unsigned char* lds = F.lds;
    const bf16_t* Q = (const bf16_t*)(F.ws + WS_Q); const bf16_t* KV = (const bf16_t*)(F.ws + WS_KV); bf16_t* Y = (bf16_t*)(F.ws + WS_Y);
    const int b = item >> 5, blk = (item >> 1) & 15, kvh = item & 1;
    const int tok0 = b * SEQ + blk * 128, tid = F.tid, lane = F.lane, w = F.wave, r32 = lane & 31, hi = lane >> 5;
#pragma unroll
    for (int i = 0; i < 4; ++i) { const int idx = tid + 512 * i, key = idx >> 3, ch = idx & 7; const bool valid = (blk > 0) || (key >= 128);
        u32x4 kk = {0u, 0u, 0u, 0u}, vv = {0u, 0u, 0u, 0u};
        if (valid) { const bf16_t* p = KV + (size_t)(tok0 - 128 + key) * 256 + kvh * 64 + ch * 8; kk = *(const u32x4*)p; vv = *(const u32x4*)(p + 128); }
        *(LAS u32x4*)(lds + AT_K + ch * 4096 + key * 16) = kk; *(LAS u32x4*)(lds + AT_V + (ch >> 2) * 16384 + key * 64 + (ch & 3) * 16) = vv; }
    { const int hh = tid >> 7, dist = tid & 127; ((LAS float*)(lds + AT_TAB))[tid] = F.rel_bias[BUCKET[dist] * 8 + 4 * kvh + hh] * LOG2E; }
    LDS_WAIT(); __syncthreads();
    const int hl = w & 3, qh = w >> 2, h = 4 * kvh + hl;
    const float sink2 = F.sinks[h] * LOG2E;
    const LAS float* tab = (const LAS float*)(lds + AT_TAB) + hl * 128;
    LAS float* wsf = (LAS float*)(lds + AT_WS) + w * 64;
    LAS bf16_t* stg = (LAS bf16_t*)(lds + AT_OST + w * 4096);
#pragma unroll 1
    for (int qq = 0; qq < 2; ++qq) {
        const int qb = 2 * qh + qq;
        const bf16_t* qp = Q + (size_t)(tok0 + 32 * qb + r32) * 512 + h * 64 + hi * 8;
        bf16x8 qr[4];
#pragma unroll
        for (int d0 = 0; d0 < 4; ++d0) qr[d0] = *(const bf16x8*)(qp + d0 * 16);
        float mx = -1e30f;
#pragma unroll 1
        for (int kb = 0; kb < 5; ++kb) {
            const LAS unsigned char* kp = lds + AT_K + hi * 4096 + (32 * (qb + kb) + r32) * 16;
            f32x16 c = {};
#pragma unroll
            for (int d0 = 0; d0 < 4; ++d0) { const bf16x8 kf = *(const LAS bf16x8*)(kp + d0 * 8192); c = __builtin_amdgcn_mfma_f32_32x32x16_bf16(kf, qr[d0], c, 0, 0, 0); }
#pragma unroll
            for (int r = 0; r < 16; ++r) {
                const int cr = crow(r, hi), dist = 128 + r32 - 32 * kb - cr, jw = 32 * (qb + kb) + cr;
                const bool valid = (dist >= 0) && (dist < 128) && ((blk > 0) || (jw >= 128));
                const float s = valid ? c[r] + tab[dist & 127] : -1e30f;
                mx = fmaxf(mx, s);
            }
        }
        { auto rr = __builtin_amdgcn_permlane32_swap(__float_as_uint(mx), __float_as_uint(mx), false, false); mx = fmaxf(__uint_as_float(rr[0]), __uint_as_float(rr[1])); }
        mx = fmaxf(mx, sink2);
        float ls = 0.f;
        f32x16 o[2] = {{}, {}};
        const LAS unsigned char* vb = lds + AT_V + (4 * hi + ((lane & 15) >> 2)) * 64 + ((lane >> 4) & 1) * 32 + (lane & 3) * 8;
#pragma unroll 1
        for (int kb = 0; kb < 5; ++kb) {
            const LAS unsigned char* kp = lds + AT_K + hi * 4096 + (32 * (qb + kb) + r32) * 16;
            f32x16 c = {};
#pragma unroll
            for (int d0 = 0; d0 < 4; ++d0) { const bf16x8 kf = *(const LAS bf16x8*)(kp + d0 * 8192); c = __builtin_amdgcn_mfma_f32_32x32x16_bf16(kf, qr[d0], c, 0, 0, 0); }
#pragma unroll
            for (int r = 0; r < 16; ++r) {
                const int cr = crow(r, hi), dist = 128 + r32 - 32 * kb - cr, jw = 32 * (qb + kb) + cr;
                const bool valid = (dist >= 0) && (dist < 128) && ((blk > 0) || (jw >= 128));
                const float e = valid ? __builtin_amdgcn_exp2f(c[r] + tab[dist & 127] - mx) : 0.f;
                c[r] = e; ls += e;
            }
#pragma unroll
            for (int s2 = 0; s2 < 2; ++s2) {
                u32x4 pw; pw.x = cvtpk(c[8 * s2 + 0], c[8 * s2 + 1]); pw.y = cvtpk(c[8 * s2 + 2], c[8 * s2 + 3]); pw.z = cvtpk(c[8 * s2 + 4], c[8 * s2 + 5]); pw.w = cvtpk(c[8 * s2 + 6], c[8 * s2 + 7]);
                const bf16x8 pa = __builtin_bit_cast(bf16x8, pw);
                const LAS unsigned char* vk = vb + (32 * (qb + kb) + 16 * s2) * 64;
#pragma unroll
                for (int d0 = 0; d0 < 2; ++d0) { const s16x4 lo = tr16(vk + d0 * 16384), hh = tr16(vk + d0 * 16384 + 512);
                    const bf16x8 vf = {lo[0], lo[1], lo[2], lo[3], hh[0], hh[1], hh[2], hh[3]};
                    o[d0] = __builtin_amdgcn_mfma_f32_32x32x16_bf16(pa, vf, o[d0], 0, 0, 0); }
            }
        }
        { auto rr = __builtin_amdgcn_permlane32_swap(__float_as_uint(ls), __float_as_uint(ls), false, false); ls = __uint_as_float(rr[0]) + __uint_as_float(rr[1]); }
        ls += __builtin_amdgcn_exp2f(sink2 - mx);
        if (hi == 0) wsf[r32] = ls;
        LDS_WAIT(); asm volatile("" ::: "memory");
#pragma unroll
        for (int r = 0; r < 16; ++r) { const int orow = crow(r, hi); const float rl = __builtin_amdgcn_rcpf(wsf[orow]);
#pragma unroll
            for (int d0 = 0; d0 < 2; ++d0) stg[orow * 64 + d0 * 32 + r32] = (bf16_t)f2bf(o[d0][r] * rl); }
        LDS_WAIT(); asm volatile("" ::: "memory");
        bf16_t* yp = Y + (size_t)(tok0 + 32 * qb) * 1024 + h * 64;
#pragma unroll
        for (int i = 0; i < 4; ++i) { const int row = i * 8 + (lane >> 3), ch = lane & 7; const u32x4 v = *(const LAS u32x4*)(stg + row * 64 + ch * 8); *(u32x4*)(yp + (size_t)row * 1024 + ch * 8) = v; }
        LDS_WAIT(); asm volatile("" ::: "memory");
    }
    __syncthreads();
}

__device__ __forceinline__ void p7_final(Frame& F) {
    const float* SS2 = (const float*)(F.ws + WS_SS2);
    const int gw = F.vcu * 8 + F.wave, NGW = F.G * 8;
    f32x4 gf[4];
#pragma unroll
    for (int j = 0; j < 4; ++j) gf[j] = *((const f32x4*)F.g_final + F.lane + 64 * j);
    for (int m = gw; m < T; m += NGW) {
        const f32x4 p = *(const f32x4*)(SS2 + (size_t)m * 4);
        const float r = __builtin_amdgcn_rsqf(((p[0] + p[1]) + (p[2] + p[3])) * (1.f / DM) + EPS);
        GAS f32x4* xr = (GAS f32x4*)(F.out + (size_t)m * DM) + F.lane;
#pragma unroll
        for (int j = 0; j < 4; ++j) { f32x4 v = xr[64 * j]; v = v * r * gf[j]; xr[64 * j] = v; }
    }
}

struct Args { const float* in[17]; float* out; unsigned char* ws; int ph_lo, ph_hi, li, pad; };
__global__ void __launch_bounds__(512, 2) mk_fwd(Args args) {
    extern __shared__ __attribute__((aligned(16))) unsigned char lds_raw[];
    Frame F;
    F.lds = (LAS unsigned char*)lds_raw;
    F.tid = threadIdx.x; F.lane = F.tid & 63; F.wave = __builtin_amdgcn_readfirstlane(F.tid >> 6);
    F.G = gridDim.x; { const int bx = blockIdx.x; F.vcu = (F.G % 8 == 0) ? (bx % 8) * (F.G / 8) + bx / 8 : bx; }
    F.x = args.in[0]; F.g_mix = args.in[1]; F.w_in = args.in[2]; F.g_sgu = args.in[3]; F.w_s = args.in[4]; F.b_s = args.in[5]; F.sinks = args.in[6]; F.rel_bias = args.in[7];
    F.w_pa = args.in[8]; F.w_pb = args.in[9]; F.w_out = args.in[10]; F.g_ffn = args.in[11]; F.w_up = args.in[12]; F.w_conv = args.in[13]; F.b_conv = args.in[14]; F.w_down = args.in[15]; F.g_final = args.in[16];
    F.out = args.out; F.ws = args.ws;
    unsigned* ctl = (unsigned*)(F.ws + WS_CTL);
    volatile LAS unsigned* MISC = (volatile LAS unsigned*)(F.lds + LDSCTL_OFF);
    for (int u = F.tid; u < (LDS_BYTES - LDSCTL_OFF) / 4; u += 512) ((LAS unsigned*)(F.lds + LDSCTL_OFF))[u] = 0u;
    __syncthreads();
    XcdBarrier bar; bar.bar = ctl + CW_BAR + args.li * XCD_BAR_WORDS; bar.x = 0; bar.st = nullptr;
    if (MK_N_LAUNCHES != NPHASE) bar = xcd_barrier_post(ctl + CW_BAR + args.li * XCD_BAR_WORDS, MISC + 8);
    const int lo = args.ph_lo, hi = args.ph_hi;
#define IN(k) (((MK_PHASE_MASK >> (k)) & 1) && lo <= (k) && (k) < hi)
#define BOTH(k) (IN(k) && IN((k) + 1))
#define GRID_BAR() do { if (MK_N_LAUNCHES != NPHASE) xcd_barrier(bar); } while (0)
    LAS unsigned char* ring = F.lds; LAS unsigned char* side = F.lds + SIDE_OFF;
    bf16_t* XN = (bf16_t*)(F.ws + WS_XN); bf16_t* MG = (bf16_t*)(F.ws + WS_MG); bf16_t* Y = (bf16_t*)(F.ws + WS_Y); bf16_t* Hb = (bf16_t*)(F.ws + WS_H);
    float* SS1 = (float*)(F.ws + WS_SS1); float* SS2 = (float*)(F.ws + WS_SS2);

    if (IN(0)) { p0_prologue(F); if (BOTH(0)) GRID_BAR(); }

    if (IN(1)) {
        pg8::Gemm g{(const char*)XN, (const char*)(F.ws + WS_WIN), (size_t)256 * 1024 * 2, (size_t)128 * 1024 * 2, (size_t)256 * 1024 * 2, (size_t)128 * 1024 * 2, 1024};
        pg8::StaticOrder S; S.init(T, IN_DIM, F.G, (int)blockIdx.x);
        pg8::EpiP1 E{(bf16_t*)(F.ws + WS_U), (bf16_t*)(F.ws + WS_VV), (bf16_t*)(F.ws + WS_Q), (bf16_t*)(F.ws + WS_KV), (bf16_t*)(F.ws + WS_GA), (bf16_t*)(F.ws + WS_GB), (float*)(F.ws + WS_VSS)};
        pg8::gemm_phase<pg8::MapNat, false>(ring, side, g, S, E);
        if (BOTH(1)) GRID_BAR();
    }

    if (IN(2)) {
        for (int it = F.vcu; it < 256; it += F.G) { sgu_unit(F, it); attn_unit(F, 2 * it); attn_unit(F, 2 * it + 1); }
        if (BOTH(2)) GRID_BAR();
    }

    if (IN(3)) {
        pg8::Gemm g{(const char*)Y, (const char*)(F.ws + WS_WP), (size_t)256 * 1024 * 2, (size_t)128 * 1024 * 2, (size_t)256 * 1024 * 2, (size_t)128 * 1024 * 2, 1024};
        pg8::StaticOrder S; S.init(T, 1024, F.G, (int)blockIdx.x);
        pg8::EpiP3 E{(const bf16_t*)(F.ws + WS_GA), (const bf16_t*)(F.ws + WS_GB), MG};
        pg8::gemm_phase<pg8::MapNat, true>(ring, side, g, S, E);
        if (BOTH(3)) GRID_BAR();
    }

    if (IN(4)) {
        pg8::Gemm g{(const char*)MG, (const char*)(F.ws + WS_WOUT), (size_t)256 * 1024 * 2, (size_t)128 * 1024 * 2, (size_t)256 * 1024 * 2, (size_t)128 * 1024 * 2, 1024};
        pg8::StaticOrder S; S.init(T, 1024, F.G, (int)blockIdx.x);
        pg8::EpiRes<true> E{F.x, F.out, XN, SS1};
        pg8::gemm_phase<pg8::MapNat, false>(ring, side, g, S, E);
        if (BOTH(4)) GRID_BAR();
    }

    if (IN(5)) {
        pg8::Gemm g{(const char*)XN, (const char*)(F.ws + WS_WUP), (size_t)256 * 1024 * 2, (size_t)4 * 1024 * 2, (size_t)256 * 1024 * 2, (size_t)128 * 1024 * 2, 1024};
        pg8::StaticOrder S; S.init(T, UPN, F.G, (int)blockIdx.x);
        pg8::EpiP5 E{SS1, F.w_conv, F.b_conv, Hb, (unsigned long long*)(F.ws + WS_GH), ctl + CW_TMO};
        pg8::gemm_phase<pg8::MapConv, false>(ring, side, g, S, E);
        if (BOTH(5)) GRID_BAR();
    }

    if (IN(6)) {
        pg8::Gemm g{(const char*)Hb, (const char*)(F.ws + WS_WDN), (size_t)256 * DFF * 2, (size_t)128 * DFF * 2, (size_t)256 * DFF * 2, (size_t)128 * DFF * 2, DFF};
        pg8::StaticOrder S; S.init(T, 1024, F.G, (int)blockIdx.x);
        pg8::EpiRes<false> E{F.out, F.out, nullptr, SS2};
        pg8::gemm_phase<pg8::MapNat, false>(ring, side, g, S, E);
        if (BOTH(6)) GRID_BAR();
    }

    if (IN(7)) p7_final(F);
#undef IN
#undef BOTH
#undef GRID_BAR
}

extern "C" void kernel_launch(void* const* d_in, const int* in_sizes, int n_in, void* d_out, int out_size, void* d_ws, size_t ws_size, hipStream_t stream) {
    static int grid = 0;
    if (grid == 0) {
        if (n_in != 17 || in_sizes[0] != T * DM || out_size != T * DM || ws_size < WS_END) { fprintf(stderr, "kernel_launch: unexpected shapes (n_in %d, in0 %d, out %d, ws %zu); nothing launched\n", n_in, n_in > 0 ? in_sizes[0] : -1, out_size, ws_size); grid = -1; return; }
        int dev = 0, cus = 0, per_cu = 0;
        if (hipGetDevice(&dev) != hipSuccess || hipDeviceGetAttribute(&cus, hipDeviceAttributeMultiprocessorCount, dev) != hipSuccess) { grid = -1; return; }
        if (hipFuncSetAttribute((const void*)mk_fwd, hipFuncAttributeMaxDynamicSharedMemorySize, LDS_BYTES) != hipSuccess) { fprintf(stderr, "kernel_launch: hipFuncSetAttribute failed\n"); grid = -1; return; }
        if (hipOccupancyMaxActiveBlocksPerMultiprocessor(&per_cu, (const void*)mk_fwd, 512, LDS_BYTES) != hipSuccess || per_cu < 1) { fprintf(stderr, "kernel_launch: occupancy query says %d blocks per CU\n", per_cu); (void)hipGetLastError(); per_cu = 1; }
        grid = cus;
        if (grid > 256) grid = 256;
    }
    if (grid < 0) return;
    (void)hipMemsetAsync((char*)d_ws + WS_CTL, 0, CTL_ZERO_BYTES, stream);
    Args a{};
    for (int i = 0; i < 17; ++i) a.in[i] = (const float*)d_in[i];
    a.out = (float*)d_out; a.ws = (unsigned char*)d_ws;
    if (MK_N_LAUNCHES == 1) { a.ph_lo = 0; a.ph_hi = NPHASE; a.li = 0; hipLaunchKernelGGL(mk_fwd, dim3(grid), dim3(512), LDS_BYTES, stream, a); }
    else for (int li = 0; li < NPHASE; ++li) { a.ph_lo = li; a.ph_hi = li + 1; a.li = 0; hipLaunchKernelGGL(mk_fwd, dim3(grid), dim3(512), LDS_BYTES, stream, a); }
}
```
